# Optimizing an MI355X kernel written in HIP

```python
import jax, jax.numpy as jnp
from jax import lax
import numpy as np

D_MODEL = 1024
BATCH = 2
SEQ = 8192
DEPTH = 4
DEC_BATCH = 128
DEC_SEQ = 8
PAST_LEN = 8192
PAGE_SIZE = 128

N_A_LAYERS = DEPTH // 2
N_B_LAYERS = DEPTH - N_A_LAYERS
CHUNK = 128
SGU_WIDTH = D_MODEL
SGU_GROUPS = 8
SGU_GROUP_DIM = SGU_WIDTH // SGU_GROUPS
HEAD_DIM = 64
N_Q_HEADS = D_MODEL // HEAD_DIM
N_KV_HEADS = 2
Q_PER_KV = N_Q_HEADS // N_KV_HEADS
WINDOW = 128
D_FF = -(-8 * D_MODEL // (3 * 256)) * 256
RMS_EPS = 1e-6
LN_EPS = 1e-5

kernel_name = "yoco_gmlp_swa_sink_decoder_step"


def rms_norm(x, g):
    xf = x.astype(jnp.float32)
    y = xf * lax.rsqrt(jnp.mean(xf * xf, axis=-1, keepdims=True) + RMS_EPS)
    return (y * g.astype(jnp.float32)).astype(x.dtype)


def layer_norm(x, g, b):
    xf = x.astype(jnp.float32)
    mu = jnp.mean(xf, axis=-1, keepdims=True)
    var = jnp.mean(jnp.square(xf - mu), axis=-1, keepdims=True)
    y = (xf - mu) * lax.rsqrt(var + LN_EPS)
    return (y * g.astype(jnp.float32) + b.astype(jnp.float32)).astype(x.dtype)


def swiglu_ffn(h, w_gate, w_up, w_down):
    return (jax.nn.silu(h @ w_gate) * (h @ w_up)) @ w_down


def gmlp_mixer(h, n, w_in, ln_g, ln_b, w_s, b_s, w_out):
    B, S, _ = h.shape
    z = jax.nn.gelu(h @ w_in, approximate=False)
    u, v = jnp.split(z, 2, axis=-1)
    v = layer_norm(v, ln_g, ln_b)
    vc = v.reshape(B, S // n, n, SGU_GROUPS, SGU_GROUP_DIM)
    causal = jnp.tril(jnp.ones((n, n), dtype=bool))
    w = jnp.where(causal, w_s[:, :n, :n], 0.0)
    mixed = jnp.einsum('gts,bcsgd->bctgd', w, vc) + b_s[:, :n].T[:, :, None]
    y = u * mixed.reshape(B, S, SGU_WIDTH)
    v_rows = vc[:, -1].reshape(B, n, SGU_WIDTH)
    return y @ w_out, v_rows


def sink_softmax(scores, sink):
    s = jnp.broadcast_to(sink.astype(jnp.float32)[:, :, None, None], scores.shape[:-1] + (1,))
    probs = jax.nn.softmax(jnp.concatenate([scores, s], axis=-1), axis=-1)
    return probs[..., :-1]


def swa_prompt(q, k, v, sinks):
    B, S = q.shape[:2]
    nb = S // WINDOW
    qb = q.reshape(B, nb, WINDOW, N_KV_HEADS, Q_PER_KV, HEAD_DIM)
    kb = k.reshape(B, nb, WINDOW, N_KV_HEADS, HEAD_DIM)
    vb = v.reshape(B, nb, WINDOW, N_KV_HEADS, HEAD_DIM)
    pad = ((0, 0), (1, 0), (0, 0), (0, 0), (0, 0))
    kk = jnp.concatenate([jnp.pad(kb, pad)[:, :-1], kb], axis=2)
    vv = jnp.concatenate([jnp.pad(vb, pad)[:, :-1], vb], axis=2)
    qpos = jnp.arange(WINDOW)[:, None] + WINDOW
    kpos = jnp.arange(2 * WINDOW)[None, :]
    band = (kpos <= qpos) & (qpos - kpos < WINDOW)
    blk = jnp.arange(nb)[:, None, None]
    valid = band[None] & ((blk > 0) | (kpos[None] >= WINDOW))
    scores = jnp.einsum('bnqkgd,bnskd->bnkgqs', qb, kk,
                        preferred_element_type=jnp.float32) * (HEAD_DIM ** -0.5)
    scores = jnp.where(valid[None, :, None, None], scores, -jnp.inf)
    probs = sink_softmax(scores, sinks.reshape(N_KV_HEADS, Q_PER_KV))
    out = jnp.einsum('bnkgqs,bnskd->bnqkgd', probs.astype(vv.dtype), vv)
    return out.reshape(B, S, N_Q_HEADS * HEAD_DIM)


def swa_sample(q, k_new, v_new, cache_k, cache_v, sinks):
    DB, T = q.shape[:2]
    cw = cache_k.shape[1]
    kk = jnp.concatenate([cache_k.astype(k_new.dtype), k_new], axis=1)
    vv = jnp.concatenate([cache_v.astype(v_new.dtype), v_new], axis=1)
    qpos = PAST_LEN + jnp.arange(T)
    kpos = jnp.concatenate([PAST_LEN - cw + jnp.arange(cw), PAST_LEN + jnp.arange(T)])
    valid = (kpos[None, :] <= qpos[:, None]) & (qpos[:, None] - kpos[None, :] < WINDOW)
    qg = q.reshape(DB, T, N_KV_HEADS, Q_PER_KV, HEAD_DIM)
    scores = jnp.einsum('btkgd,bskd->bkgts', qg, kk,
                        preferred_element_type=jnp.float32) * (HEAD_DIM ** -0.5)
    scores = jnp.where(valid, scores, -jnp.inf)
    probs = sink_softmax(scores, sinks.reshape(N_KV_HEADS, Q_PER_KV))
    out = jnp.einsum('bkgts,bskd->btkgd', probs.astype(vv.dtype), vv)
    return out.reshape(DB, T, N_Q_HEADS * HEAD_DIM)


def trunk(x, is_prompt, cache_k, cache_v, sg_norm_pre, sg_w_in, sg_ln_g, sg_ln_b, sg_w_s, sg_b_s,
          sg_w_out, sg_norm_post, kv_norm, w_kv, b_kv, sw_norm_pre, sw_w_q, sw_b_q, sw_sinks,
          sw_w_o, sw_b_o, sw_norm_post, f_norm_pre, f_w_gate, f_w_up, f_w_down, f_norm_post):
    B, S, _ = x.shape
    n = CHUNK if is_prompt else S
    v_rows = []
    k_sh = v_sh = None
    for layer in range(DEPTH):
        if layer < N_A_LAYERS:
            i = layer
            h = rms_norm(x, sg_norm_pre[i])
            out, vr = gmlp_mixer(h, n, sg_w_in[i], sg_ln_g[i], sg_ln_b[i], sg_w_s[i], sg_b_s[i], sg_w_out[i])
            v_rows.append(vr)
        else:
            i = layer - N_A_LAYERS
            if i == 0:
                kv = rms_norm(x, kv_norm) @ w_kv + b_kv
                k_sh, v_sh = jnp.split(kv.reshape(B, S, 2 * N_KV_HEADS, HEAD_DIM), 2, axis=2)
            h = rms_norm(x, sw_norm_pre[i])
            q = (h @ sw_w_q[i] + sw_b_q[i]).reshape(B, S, N_Q_HEADS, HEAD_DIM)
            if is_prompt:
                att = swa_prompt(q, k_sh, v_sh, sw_sinks[i])
            else:
                att = swa_sample(q, k_sh, v_sh, cache_k, cache_v, sw_sinks[i])
            out = att @ sw_w_o[i] + sw_b_o[i]
            norm_post = sw_norm_post[i]
        x = x + rms_norm(out, sg_norm_post[layer] if layer < N_A_LAYERS else sw_norm_post[layer - N_A_LAYERS])
        h = rms_norm(x, f_norm_pre[layer])
        x = x + rms_norm(swiglu_ffn(h, f_w_gate[layer], f_w_up[layer], f_w_down[layer]), f_norm_post[layer])
    return x, jnp.stack(v_rows, axis=0), k_sh, v_sh


def setup_inputs(seed: int = 0) -> dict:
    key = jax.random.key(seed)
    ks = iter(jax.random.split(key, 40))
    nrm = lambda shape, scale: jax.random.normal(next(ks), shape, jnp.float32) * scale
    cache_rows = min(WINDOW, PAST_LEN)
    qw = N_Q_HEADS * HEAD_DIM
    kvw = N_KV_HEADS * HEAD_DIM
    na, nb_, d = N_A_LAYERS, N_B_LAYERS, D_MODEL
    return {
        'x_prompt': nrm((BATCH, SEQ, d), 1.0),
        'x_sample': nrm((DEC_BATCH, DEC_SEQ, d), 1.0),
        'cache_k': nrm((DEC_BATCH, cache_rows, N_KV_HEADS, HEAD_DIM), 1.0),
        'cache_v': nrm((DEC_BATCH, cache_rows, N_KV_HEADS, HEAD_DIM), 1.0),
        'sg_norm_pre': 1.0 + nrm((na, d), 0.05),
        'sg_w_in': nrm((na, d, 2 * SGU_WIDTH), d ** -0.5),
        'sg_ln_g': 1.0 + nrm((na, SGU_WIDTH), 0.05),
        'sg_ln_b': nrm((na, SGU_WIDTH), 0.02),
        'sg_w_s': nrm((na, SGU_GROUPS, CHUNK, CHUNK), 0.5 * CHUNK ** -0.5),
        'sg_b_s': 1.0 + nrm((na, SGU_GROUPS, CHUNK), 0.1),
        'sg_w_out': nrm((na, SGU_WIDTH, d), SGU_WIDTH ** -0.5),
        'sg_norm_post': 1.0 + nrm((na, d), 0.05),
        'kv_norm': 1.0 + nrm((d,), 0.05),
        'w_kv': nrm((d, 2 * kvw), d ** -0.5),
        'b_kv': nrm((2 * kvw,), 0.02),
        'sw_norm_pre': 1.0 + nrm((nb_, d), 0.05),
        'sw_w_q': nrm((nb_, d, qw), d ** -0.5),
        'sw_b_q': nrm((nb_, qw), 0.02),
        'sw_sinks': nrm((nb_, N_Q_HEADS), 0.5),
        'sw_w_o': nrm((nb_, qw, d), qw ** -0.5),
        'sw_b_o': nrm((nb_, d), 0.02),
        'sw_norm_post': 1.0 + nrm((nb_, d), 0.05),
        'f_norm_pre': 1.0 + nrm((DEPTH, d), 0.05),
        'f_w_gate': nrm((DEPTH, d, D_FF), d ** -0.5),
        'f_w_up': nrm((DEPTH, d, D_FF), d ** -0.5),
        'f_w_down': nrm((DEPTH, D_FF, d), D_FF ** -0.5),
        'f_norm_post': 1.0 + nrm((DEPTH, d), 0.05),
    }


def reference(x_prompt, x_sample, cache_k, cache_v, sg_norm_pre, sg_w_in, sg_ln_g, sg_ln_b, sg_w_s,
              sg_b_s, sg_w_out, sg_norm_post, kv_norm, w_kv, b_kv, sw_norm_pre, sw_w_q, sw_b_q,
              sw_sinks, sw_w_o, sw_b_o, sw_norm_post, f_norm_pre, f_w_gate, f_w_up, f_w_down,
              f_norm_post):
    weights = (sg_norm_pre, sg_w_in, sg_ln_g, sg_ln_b, sg_w_s, sg_b_s, sg_w_out, sg_norm_post,
               kv_norm, w_kv, b_kv, sw_norm_pre, sw_w_q, sw_b_q, sw_sinks, sw_w_o, sw_b_o,
               sw_norm_post, f_norm_pre, f_w_gate, f_w_up, f_w_down, f_norm_post)
    y_prompt, v_rows_prompt, k_p, v_p = trunk(x_prompt, True, None, None, *weights)
    y_sample, v_rows_sample, k_s, v_s = trunk(x_sample, False, cache_k, cache_v, *weights)
    k_prompt = k_p[:, -WINDOW:]
    v_prompt = v_p[:, -WINDOW:]
    return (y_prompt, y_sample, v_rows_prompt, v_rows_sample, k_prompt, v_prompt, k_s, v_s)
```

```cpp
#include <hip/hip_runtime.h>
#include <cstdio>
#include <cstdint>

namespace pg8 {
#define PG8_LAS __attribute__((address_space(3)))
typedef unsigned short bf16_t;
typedef short bf16x8 __attribute__((ext_vector_type(8)));
typedef float f32x4 __attribute__((ext_vector_type(4)));
typedef unsigned u32x4 __attribute__((ext_vector_type(4)));
constexpr int BM = 256, BK = 64, HALF = 128, HTB = HALF * BK * 2  , STAGE_BYTES = 8 * HTB, NXCD = 8, WGM = 8;

__host__ __device__ __forceinline__ int lds_byte(int r, int c) { const int st = (r >> 4) * 2 + (c >> 5), rr = r & 15, cc = c & 31, ob = rr * 64 + cc * 2; return st * 1024 + (ob ^ (((ob >> 9) & 1) << 5)); }
__host__ __device__ __forceinline__ void stage_rc(int b, int& R, int& C) { const int st = b / 1024, sb = b % 1024, swz = sb ^ (((sb >> 9) & 1) << 5); R = (st >> 1) * 16 + swz / 64; C = (st & 1) * 32 + (swz % 64) / 2; }
__host__ __device__ __forceinline__ int perm32(int rho) { const int n = rho >> 4, i = rho & 15; return 8 * (i >> 2) + 4 * n + (i & 3); }

struct Unit { int pm, pn; };
struct Gemm { const bf16_t* A; const bf16_t* Bt; int M, N, K; };

struct StaticOrder {
    int nM, nN, nwg, G, c;
    __host__ __device__ void init(int M, int N, int G_, int c_) { nM = M / BM; nN = N / BM; nwg = nM * nN; G = G_; c = c_; }
    __host__ __device__ bool next(int i, Unit& u) const {
        const long L = (long)i * G + c; if (L >= nwg) return false;
        int wgid = (int)L; { const int q = nwg / NXCD, r = nwg % NXCD, xcd = wgid % NXCD, off = wgid / NXCD; wgid = (xcd < r ? xcd * (q + 1) : r * (q + 1) + (xcd - r) * q) + off; }
        const int nig = WGM * nN, gid = wgid / nig, fm = gid * WGM, gsz = (nM - fm) < WGM ? (nM - fm) : WGM;
        u.pm = fm + ((wgid % nig) % gsz); u.pn = (wgid % nig) / gsz; return true;
    }
    __device__ __forceinline__ void a_ready(const Unit&) const {}
    __device__ __forceinline__ void done(const Unit&) const {}
};

__device__ __forceinline__ unsigned cvt_pk_bf16(float lo, float hi) { unsigned r; asm volatile("v_cvt_pk_bf16_f32 %0, %1, %2" : "=v"(r) : "v"(lo), "v"(hi)); return r; }
typedef float f32x2 __attribute__((ext_vector_type(2)));
__device__ __forceinline__ f32x2 gelu_pk(f32x2 v) {
    const f32x2 av = __builtin_elementwise_abs(v), d = av * 0.2316418882f + 1.0f;
    f32x2 t; t.x = __builtin_amdgcn_rcpf(d.x); t.y = __builtin_amdgcn_rcpf(d.y);
    f32x2 q = t * 0.5307027145f + (-0.7265760135f); q = q * t + 0.7107068705f; q = q * t + (-0.142248368f); q = q * t + 0.127414796f; q = q * t;
    const f32x2 s = (v * v) * (-0.72134752044f);
    f32x2 e; e.x = __builtin_amdgcn_exp2f(s.x); e.y = __builtin_amdgcn_exp2f(s.y);
    const f32x2 m = v * (q * e), r = v - m;
    f32x2 o; o.x = v.x < 0.f ? m.x : r.x; o.y = v.y < 0.f ? m.y : r.y; return o;
}

template <int ACT  > struct EpiBf16 {
    static constexpr bool PERM = true, AFTER_DRAIN = false; static_assert(ACT == 0 || ACT == 1, "EpiBf16: ACT is 0 (none) or 1 (gelu_pk)");
    bf16_t* O; int ldc; const float* bias; int split_cols; size_t split_stride; float scale0;
    __device__ __forceinline__ void operator()(const f32x4 (&acc)[2][2][4][2], const Unit& u, int wr, int wc, int fr, int fq) const {
        const int row0 = u.pm * BM + wr * 64 + fr; int colt = u.pn * BM; bf16_t* base = O;
        float sc = 1.f; if (split_cols) { const int t = colt / split_cols; base += (size_t)t * split_stride; colt -= t * split_cols; if (t == 0) sc = scale0; }
        const int col0 = colt + wc * 32 + 8 * fq, bcol0 = u.pn * BM + wc * 32 + 8 * fq;
        f32x4 bv[2][2];
#pragma unroll
        for (int bj = 0; bj < 2; ++bj)
#pragma unroll
            for (int n = 0; n < 2; ++n) bv[bj][n] = bias ? *(const f32x4*)(bias + bcol0 + bj * HALF + 4 * n) : (f32x4){0.f, 0.f, 0.f, 0.f};
#pragma unroll
        for (int ai = 0; ai < 2; ++ai)
#pragma unroll
            for (int m = 0; m < 4; ++m) { bf16_t* rowp = base + (size_t)(row0 + ai * HALF + m * 16) * ldc + col0;
#pragma unroll
                for (int bj = 0; bj < 2; ++bj) { f32x4 v0 = acc[ai][bj][m][0] + bv[bj][0], v1 = acc[ai][bj][m][1] + bv[bj][1];
                    if (ACT == 1) { f32x2 a = gelu_pk((f32x2){v0[0], v0[1]}), b = gelu_pk((f32x2){v0[2], v0[3]}), c = gelu_pk((f32x2){v1[0], v1[1]}), d = gelu_pk((f32x2){v1[2], v1[3]});
                        v0 = (f32x4){a.x, a.y, b.x, b.y}; v1 = (f32x4){c.x, c.y, d.x, d.y}; }
                    v0 = v0 * sc; v1 = v1 * sc; u32x4 w; w.x = cvt_pk_bf16(v0[0], v0[1]); w.y = cvt_pk_bf16(v0[2], v0[3]); w.z = cvt_pk_bf16(v1[0], v1[1]); w.w = cvt_pk_bf16(v1[2], v1[3]);
                    *(u32x4*)(rowp + bj * HALF) = w; } }
    }
};

typedef float f32x2v __attribute__((ext_vector_type(2)));
struct EpiGeluUV {
    static constexpr bool PERM = true, AFTER_DRAIN = false;
    bf16_t* U; bf16_t* V; float* vstat;
    __device__ __forceinline__ void operator()(const f32x4 (&acc)[2][2][4][2], const Unit& u, int wr, int wc, int fr, int fq) const {
        const int row0 = u.pm * BM + wr * 64 + fr; const bool isv = u.pn >= 4;
        bf16_t* base = isv ? V : U; const int col0 = (u.pn & 3) * BM + wc * 32 + 8 * fq;
#pragma unroll
        for (int ai = 0; ai < 2; ++ai)
#pragma unroll
            for (int m = 0; m < 4; ++m) { const int row = row0 + ai * HALF + m * 16; bf16_t* rowp = base + (size_t)row * 1024 + col0; float s = 0.f, q = 0.f;
#pragma unroll
                for (int bj = 0; bj < 2; ++bj) { const f32x4 v0 = acc[ai][bj][m][0], v1 = acc[ai][bj][m][1];
                    const f32x2 a = gelu_pk((f32x2){v0[0], v0[1]}), b = gelu_pk((f32x2){v0[2], v0[3]}), c = gelu_pk((f32x2){v1[0], v1[1]}), d = gelu_pk((f32x2){v1[2], v1[3]});
                    s += ((a.x + a.y) + (b.x + b.y)) + ((c.x + c.y) + (d.x + d.y));
                    q += ((a.x * a.x + a.y * a.y) + (b.x * b.x + b.y * b.y)) + ((c.x * c.x + c.y * c.y) + (d.x * d.x + d.y * d.y));
                    u32x4 w; w.x = cvt_pk_bf16(a.x, a.y); w.y = cvt_pk_bf16(b.x, b.y); w.z = cvt_pk_bf16(c.x, c.y); w.w = cvt_pk_bf16(d.x, d.y);
                    *(u32x4*)(rowp + bj * HALF) = w; }
                if (isv) { s += __shfl_xor(s, 16); s += __shfl_xor(s, 32); q += __shfl_xor(q, 16); q += __shfl_xor(q, 32);
                    if (fq == 0) *(f32x2v*)(vstat + ((size_t)row * 16 + (u.pn - 4) * 4 + wc) * 2) = (f32x2v){s, q}; } }
    }
};
struct EpiSwiglu {
    static constexpr bool PERM = true, AFTER_DRAIN = false;
    bf16_t* H; int ldh;
    __device__ __forceinline__ void operator()(const f32x4 (&acc)[2][2][4][2], const Unit& u, int wr, int wc, int fr, int fq) const {
        const int row0 = u.pm * BM + wr * 64 + fr; const int col0 = u.pn * HALF + wc * 32 + 8 * fq;
#pragma unroll
        for (int ai = 0; ai < 2; ++ai)
#pragma unroll
            for (int m = 0; m < 4; ++m) { bf16_t* rowp = H + (size_t)(row0 + ai * HALF + m * 16) * ldh + col0; float h[8];
#pragma unroll
                for (int n = 0; n < 2; ++n)
#pragma unroll
                    for (int j = 0; j < 4; ++j) { const float g = acc[ai][0][m][n][j], up = acc[ai][1][m][n][j];
                        h[4 * n + j] = g * __builtin_amdgcn_rcpf(1.0f + __builtin_amdgcn_exp2f(g * -1.4426950408889634f)) * up; }
                u32x4 w; w.x = cvt_pk_bf16(h[0], h[1]); w.y = cvt_pk_bf16(h[2], h[3]); w.z = cvt_pk_bf16(h[4], h[5]); w.w = cvt_pk_bf16(h[6], h[7]);
                *(u32x4*)rowp = w; }
    }
};
template <class Epi, class Sched, bool ALIGN_EPI = false, bool SP2 = false>
__device__ __forceinline__ void gemm_phase(PG8_LAS unsigned char* lds, const Gemm g, const Sched& S, const Epi& E) {
    int tid_ = threadIdx.x; asm volatile("" : "+v"(tid_));
    const int tid = tid_, wid = __builtin_amdgcn_readfirstlane(tid >> 6), lane = tid & 63, wr = wid >> 2, wc = wid & 3, fr = lane & 15, fq = lane >> 4;
    const int K = g.K, nt = K / BK;
    unsigned voffA[2], voffB[2];
#pragma unroll
    for (int i = 0; i < 2; ++i) { int R, C; stage_rc(tid * 16 + i * 8192, R, C); const int Rb = Epi::PERM ? ((R & ~31) + perm32(R & 31)) : R;
        voffA[i] = (unsigned)(R * K + C) * 2u; voffB[i] = (unsigned)(Rb * K + C) * 2u; }
    const size_t kstep = (size_t)(BK * 2);
    const size_t hstep = (size_t)HALF * K * 2;
    const size_t tstep = 2 * hstep;
    const unsigned ldsw = (unsigned)wid * 1024u;
    const int aoff = lds_byte(wr * 64 + fr, fq * 8), boff = lds_byte(wc * 32 + fr, fq * 8);
#define PG8_SA(b, h) (((b) * 2 + (h)) * HTB)
#define PG8_SB(b, h) ((4 + (b) * 2 + (h)) * HTB)
#define PG8_STAGE(bufoff, gbase, voff) do { _Pragma("unroll") for (int _i = 0; _i < 2; ++_i) \
        __builtin_amdgcn_global_load_lds((const unsigned*)((const char*)(gbase) + (voff)[_i]), (PG8_LAS unsigned*)(lds + (bufoff) + ldsw + _i * 8192), 16, 0, 0); } while (0)
#define PG8_LDA(dst, b, h) do { _Pragma("unroll") for (int m = 0; m < 4; ++m) _Pragma("unroll") for (int k = 0; k < 2; ++k) dst[m][k] = *(const PG8_LAS bf16x8*)(lds + PG8_SA(b, h) + aoff + m * 2048 + k * 1024); } while (0)
#define PG8_LDB(dst, b, h) do { _Pragma("unroll") for (int n = 0; n < 2; ++n) _Pragma("unroll") for (int k = 0; k < 2; ++k) dst[n][k] = *(const PG8_LAS bf16x8*)(lds + PG8_SB(b, h) + boff + n * 2048 + k * 1024); } while (0)
#define PG8_MMA(ai, bj, At, Bt) do { __builtin_amdgcn_s_setprio(1); _Pragma("unroll") for (int m = 0; m < 4; ++m) _Pragma("unroll") for (int n = 0; n < 2; ++n) _Pragma("unroll") for (int k = 0; k < 2; ++k) \
        acc[ai][bj][m][n] = __builtin_amdgcn_mfma_f32_16x16x32_bf16(Bt[n][k], At[m][k], acc[ai][bj][m][n], 0, 0, 0); __builtin_amdgcn_s_setprio(0); } while (0)
#define PG8_WAIT_V(n) asm volatile("s_waitcnt vmcnt(" #n ")" ::: "memory")
#define PG8_WAIT_L(n) asm volatile("s_waitcnt lgkmcnt(" #n ")" ::: "memory")
#define PG8_BAR __builtin_amdgcn_s_barrier()
#define PG8_SCHED __builtin_amdgcn_sched_barrier(0)
    Unit cur, nxt; int ui = 0;
    if (!S.next(0, cur)) return;
    f32x4 acc[2][2][4][2];
#pragma unroll
    for (int a = 0; a < 2; ++a)
#pragma unroll
        for (int b = 0; b < 2; ++b)
#pragma unroll
            for (int m = 0; m < 4; ++m)
#pragma unroll
                for (int n = 0; n < 2; ++n) acc[a][b][m][n] = (f32x4){0.f, 0.f, 0.f, 0.f};
    bf16x8 At[4][2], B0[2][2], B1[2][2];
    const char* cA = (const char*)g.A + (size_t)cur.pm * tstep; const char* cB = (const char*)g.Bt + (size_t)cur.pn * tstep;
    S.a_ready(cur);
    if constexpr (SP2) {
        PG8_STAGE(PG8_SB(0, 0), cB, voffB); PG8_STAGE(PG8_SB(0, 1), cB + hstep, voffB); PG8_STAGE(PG8_SA(0, 0), cA, voffA); PG8_STAGE(PG8_SA(0, 1), cA + hstep, voffA);
        if (wr == 1) PG8_BAR;
        PG8_WAIT_V(2); PG8_BAR;
        PG8_STAGE(PG8_SB(1, 0), cB + kstep, voffB); PG8_STAGE(PG8_SA(1, 0), cA + kstep, voffA); PG8_STAGE(PG8_SB(1, 1), cB + hstep + kstep, voffB);
        PG8_WAIT_V(6); PG8_BAR;
    } else {
        PG8_STAGE(PG8_SB(0, 0), cB, voffB); PG8_STAGE(PG8_SA(0, 0), cA, voffA); PG8_STAGE(PG8_SB(0, 1), cB + hstep, voffB); PG8_STAGE(PG8_SA(0, 1), cA + hstep, voffA);
        if (wr == 1) PG8_BAR;
        PG8_WAIT_V(4); PG8_BAR;
        PG8_STAGE(PG8_SB(1, 0), cB + kstep, voffB); PG8_STAGE(PG8_SA(1, 0), cA + kstep, voffA); PG8_STAGE(PG8_SB(1, 1), cB + hstep + kstep, voffB);
        PG8_WAIT_V(6); PG8_BAR;
    }
    for (;;) {
        const bool has_next = S.next(ui + 1, nxt);
        const char* nA = has_next ? (const char*)g.A + (size_t)nxt.pm * tstep : cA; const char* nB = has_next ? (const char*)g.Bt + (size_t)nxt.pn * tstep : cB;
        for (int t = 0; t < nt; t += 2) {
            const bool last = (t == nt - 2);
            const char* a1 = cA + (size_t)(t + 1) * kstep;
            const char* a2 = last ? nA : cA + (size_t)(t + 2) * kstep; const char* b2 = last ? nB : cB + (size_t)(t + 2) * kstep;
            const char* a3 = a2 + kstep; const char* b3 = b2 + kstep;
            if (last && has_next) S.a_ready(nxt);
            if constexpr (SP2) {
            PG8_LDB(B0, 0, 0); PG8_LDB(B1, 0, 1); PG8_SCHED; PG8_LDA(At, 0, 0); PG8_STAGE(PG8_SA(1, 1), a1 + hstep, voffA);
            PG8_WAIT_V(8); PG8_WAIT_L(0); PG8_BAR; PG8_MMA(0, 0, At, B0); PG8_MMA(0, 1, At, B1); PG8_BAR; PG8_SCHED;
            PG8_LDA(At, 0, 1); PG8_STAGE(PG8_SB(0, 0), b2, voffB); PG8_STAGE(PG8_SB(0, 1), b2 + hstep, voffB); PG8_STAGE(PG8_SA(0, 0), a2, voffA);
            PG8_WAIT_V(8); PG8_WAIT_L(0); PG8_BAR; PG8_MMA(1, 0, At, B0); PG8_MMA(1, 1, At, B1); PG8_BAR; PG8_SCHED;
            PG8_LDB(B0, 1, 0); PG8_LDB(B1, 1, 1); PG8_SCHED; PG8_LDA(At, 1, 0); PG8_STAGE(PG8_SA(0, 1), a2 + hstep, voffA);
            PG8_WAIT_V(8); PG8_WAIT_L(0); PG8_BAR; PG8_MMA(0, 0, At, B0); PG8_MMA(0, 1, At, B1); PG8_BAR; PG8_SCHED;
            PG8_LDA(At, 1, 1); PG8_STAGE(PG8_SB(1, 0), b3, voffB); PG8_STAGE(PG8_SB(1, 1), b3 + hstep, voffB); PG8_STAGE(PG8_SA(1, 0), a3, voffA);
            PG8_WAIT_V(8); PG8_WAIT_L(0); PG8_BAR; PG8_MMA(1, 0, At, B0); PG8_MMA(1, 1, At, B1); PG8_BAR; PG8_SCHED;
            } else {
            PG8_LDB(B0, 0, 0); PG8_SCHED; PG8_LDA(At, 0, 0); PG8_STAGE(PG8_SA(1, 1), a1 + hstep, voffA);
            PG8_WAIT_L(8); PG8_BAR; PG8_WAIT_L(0); PG8_MMA(0, 0, At, B0); PG8_BAR; PG8_SCHED;
            PG8_LDB(B1, 0, 1); PG8_STAGE(PG8_SB(0, 0), b2, voffB);
            PG8_BAR; PG8_WAIT_L(0); PG8_MMA(0, 1, At, B1); PG8_BAR;
            PG8_LDA(At, 0, 1); PG8_STAGE(PG8_SA(0, 0), a2, voffA);
            PG8_BAR; PG8_WAIT_L(0); PG8_MMA(1, 0, At, B0); PG8_BAR; PG8_SCHED;
            PG8_STAGE(PG8_SB(0, 1), b2 + hstep, voffB);
            PG8_WAIT_V(6); PG8_BAR; PG8_MMA(1, 1, At, B1); PG8_BAR;
            PG8_LDB(B0, 1, 0); PG8_SCHED; PG8_LDA(At, 1, 0); PG8_STAGE(PG8_SA(0, 1), a2 + hstep, voffA);
            PG8_WAIT_L(8); PG8_BAR; PG8_WAIT_L(0); PG8_MMA(0, 0, At, B0); PG8_BAR; PG8_SCHED;
            PG8_LDB(B1, 1, 1); PG8_STAGE(PG8_SB(1, 0), b3, voffB);
            PG8_BAR; PG8_WAIT_L(0); PG8_MMA(0, 1, At, B1); PG8_BAR;
            PG8_LDA(At, 1, 1); PG8_STAGE(PG8_SA(1, 0), a3, voffA);
            PG8_BAR; PG8_WAIT_L(0); PG8_MMA(1, 0, At, B0); PG8_BAR; PG8_SCHED;
            PG8_STAGE(PG8_SB(1, 1), b3 + hstep, voffB);
            PG8_WAIT_V(6); PG8_BAR; PG8_MMA(1, 1, At, B1); PG8_BAR;
            }
        }
        if constexpr (ALIGN_EPI) { if (wr == 0) PG8_BAR; }
        if constexpr (!Epi::AFTER_DRAIN) { E(acc, cur, wr, wc, fr, fq); S.done(cur); }
        if (!has_next) break;
#pragma unroll
        for (int a = 0; a < 2; ++a)
#pragma unroll
            for (int b = 0; b < 2; ++b)
#pragma unroll
                for (int m = 0; m < 4; ++m)
#pragma unroll
                    for (int n = 0; n < 2; ++n) acc[a][b][m][n] = (f32x4){0.f, 0.f, 0.f, 0.f};
        cur = nxt; cA = nA; cB = nB; ++ui;
        if constexpr (ALIGN_EPI) { if (wr == 1) PG8_BAR; }
    }
    PG8_WAIT_V(0);
    if constexpr (!ALIGN_EPI) { if (wr == 0) PG8_BAR; }
    PG8_BAR;
    if constexpr (Epi::AFTER_DRAIN) { E.fused(acc, cur, wr, wc, fr, fq, lds, wid, lane); S.done(cur); }
#undef PG8_SA
#undef PG8_SB
#undef PG8_STAGE
#undef PG8_LDA
#undef PG8_LDB
#undef PG8_MMA
#undef PG8_WAIT_V
#undef PG8_WAIT_L
#undef PG8_BAR
#undef PG8_SCHED
}
}

#define GAS __attribute__((address_space(1)))
#define LAS __attribute__((address_space(3)))
typedef unsigned short bf16;
typedef unsigned v4u __attribute__((ext_vector_type(4)));
typedef float f32x4 __attribute__((ext_vector_type(4)));
typedef short bf16x8 __attribute__((ext_vector_type(8)));
typedef GAS unsigned gu32;
typedef GAS unsigned long long gu64;
#define RLX_AGENT __ATOMIC_RELAXED, __HIP_MEMORY_SCOPE_AGENT
#define LDS_WAIT() asm volatile("s_waitcnt lgkmcnt(0)" ::: "memory")
#define VM_WAIT() asm volatile("s_waitcnt vmcnt(0)" ::: "memory")
__device__ __forceinline__ unsigned long long rt() { return __builtin_amdgcn_s_memrealtime(); }

#define XB_TMO      128
#define XB_XCNT(j)  (256  + 64 * (j))
#define XB_XSUB(j)  (1280 + 64 * (j))
#define XB_XGEN(j)  (2304 + 64 * (j))
#define XB_TOP      3328
#define XB_TOPGEN   3392
#define XCD_BAR_WORDS 3456
#define XB_SPIN_CAP (1u << 18)

__device__ __forceinline__ unsigned xb_ld(unsigned* p)              { return __hip_atomic_load(p, __ATOMIC_RELAXED, __HIP_MEMORY_SCOPE_AGENT); }
__device__ __forceinline__ unsigned xb_add(unsigned* p, unsigned v) { return __hip_atomic_fetch_add(p, v, __ATOMIC_RELAXED, __HIP_MEMORY_SCOPE_AGENT); }
__device__ __forceinline__ unsigned xb_xcc_id() { return (unsigned)__builtin_amdgcn_s_getreg((3 << 11) | 20) & 0xFu; }
#define XB_SPIN(cond, bar) do { unsigned _sp = 0; while (cond) { __builtin_amdgcn_s_sleep(1); \
    if ((++_sp & 255u) == 0u) { if (xb_ld(&(bar)[XB_TMO])) break; if (_sp > XB_SPIN_CAP) { atomicAdd(&(bar)[XB_TMO], 1u); break; } } } } while (0)

struct XcdBarrier {
    unsigned* bar; unsigned x;
    volatile LAS unsigned* st;
};

__device__ __forceinline__ XcdBarrier xcd_barrier_post(unsigned* bar, volatile LAS unsigned* st) {
    XcdBarrier b; b.bar = bar; b.x = xb_xcc_id(); b.st = st;
    if (threadIdx.x == 0) (void)xb_add(&bar[XB_XCNT(b.x)], 1u);
    return b;
}
__device__ __forceinline__ void xcd_barrier_complete(unsigned* bar, unsigned x, unsigned& nloc, unsigned& nx) {
    const unsigned G = gridDim.x * gridDim.y * gridDim.z;
    unsigned sum, cnt, mine, sp = 0u;
    for (;;) {
        sum = 0u; cnt = 0u; mine = 0u;
#pragma unroll
        for (unsigned j = 0; j < 16; ++j) { const unsigned c = xb_ld(&bar[XB_XCNT(j)]); sum += c; cnt += (c > 0u) ? 1u : 0u; mine = (j == x) ? c : mine; }
        if (sum == G) break;
        __builtin_amdgcn_s_sleep(1);
        if ((++sp & 255u) == 0u) { if (xb_ld(&bar[XB_TMO])) break; if (sp > XB_SPIN_CAP) { atomicAdd(&bar[XB_TMO], 1u); break; } }
    }
    nloc = mine > 0u ? mine : 1u; nx = cnt > 0u ? cnt : 1u;
}

__device__ __forceinline__ void xcd_barrier(const XcdBarrier& b) {
    asm volatile("s_waitcnt vmcnt(0)" ::: "memory");
    __syncthreads();
    if (threadIdx.x == 0) {
        unsigned* bar = b.bar;
        __builtin_amdgcn_s_waitcnt(0);
        unsigned nloc = b.st[0], nx = b.st[1];
        if (nloc == 0u) { xcd_barrier_complete(bar, b.x, nloc, nx); b.st[0] = nloc; b.st[1] = nx; }
        const unsigned old = xb_add(&bar[XB_XSUB(b.x)], 1u);
        const unsigned gen = old / nloc;
        if (old + 1u == (gen + 1u) * nloc) {
            __builtin_amdgcn_fence(__ATOMIC_RELEASE, "agent");
            asm volatile("s_waitcnt vmcnt(0)" ::: "memory");
            const unsigned og = xb_add(&bar[XB_TOP], 1u);
            const unsigned tg = og / nx;
            if (og + 1u == (tg + 1u) * nx) xb_add(&bar[XB_TOPGEN], 1u);
            else XB_SPIN(xb_ld(&bar[XB_TOPGEN]) == tg, bar);
            __builtin_amdgcn_fence(__ATOMIC_ACQUIRE, "agent");
            xb_add(&bar[XB_XGEN(b.x)], 1u);
            asm volatile("s_waitcnt vmcnt(0)" ::: "memory");
        } else {
            XB_SPIN(xb_ld(&bar[XB_XGEN(b.x)]) == gen, bar);
            __builtin_amdgcn_fence(__ATOMIC_ACQUIRE, "agent");
            asm volatile("s_waitcnt vmcnt(0)" ::: "memory");
        }
    }
    __syncthreads();
}

constexpr int NWAVES = 8;
constexpr int D = 1024, SEQ = 8192, MP = 2 * SEQ, MS = 1024, M = MP + MS, FF = 2816, NGU = 2 * FF;
constexpr float RMS_EPS = 1e-6f, LN_EPS = 1e-5f;
constexpr float LOG2E = 1.4426950408889634f, QSCALE = 0.125f * LOG2E;
constexpr size_t O_SVP = (size_t)M * D, O_SVS = O_SVP + 2ull * 2 * 128 * 1024, O_KP = O_SVS + 2ull * 128 * 8 * 1024, O_VP = O_KP + 2 * 128 * 128, O_KS = O_VP + 2 * 128 * 128, O_VS = O_KS + 128 * 8 * 128;
static_assert(O_VS + 128 * 8 * 128 == 20774912ull, "d_out size");
constexpr size_t KiB = 1024, MiB = 1u << 20;
constexpr size_t WS_CTL = 0, CTL_ZERO_BYTES = 64 * KiB;
constexpr size_t WS_WIN = 1 * MiB;
constexpr size_t WS_WOUT = WS_WIN + 2 * 4 * MiB;
constexpr size_t WS_WQKV = WS_WOUT + 2 * 2 * MiB;
constexpr size_t WS_WQ3 = WS_WQKV + 2 * MiB + 512 * KiB;
constexpr size_t WS_WO = WS_WQ3 + 2 * MiB;
constexpr size_t WS_WGU = WS_WO + 2 * 2 * MiB;
constexpr size_t WS_WD = WS_WGU + 4 * 11 * MiB;
constexpr size_t WS_WS = WS_WD + 4 * (5 * MiB + 512 * KiB);
constexpr size_t WS_VSTAT = WS_WS + 1 * MiB;
constexpr size_t WS_HN = 91 * MiB;
constexpr size_t WS_BQKV = 90 * MiB + 768 * KiB;
constexpr size_t WS_KV = 219 * MiB;
constexpr size_t WS_R = 125 * MiB;
constexpr size_t WS_U = WS_R, WS_V = WS_R + 34 * MiB, WS_QO = WS_R, WS_HID = WS_R;
constexpr size_t WS_END = WS_KV + (size_t)M * D * 2;
static_assert(WS_VSTAT + (size_t)M * 128 <= WS_HN && WS_HN + (size_t)M * D * 2 <= WS_R && WS_R + (size_t)M * FF * 2 <= WS_KV && WS_KV > WS_QO && WS_VSTAT + (size_t)M * 128 <= WS_BQKV && WS_END <= 256 * MiB && WS_WS == 87 * MiB + 512 * KiB, "d_ws map");
constexpr int CW_BAR = 1024;
constexpr int RING_BYTES = 131072, LDSCTL_OFF = RING_BYTES, MISC_OFF = LDSCTL_OFF + 320, LDS_BYTES = 147456;

typedef unsigned u32x2 __attribute__((ext_vector_type(2)));
typedef float f32x2_t __attribute__((ext_vector_type(2))); typedef __bf16 bf16x2_t __attribute__((ext_vector_type(2)));
typedef float f32x16 __attribute__((ext_vector_type(16)));
typedef short s16x4 __attribute__((ext_vector_type(4)));
__device__ __forceinline__ unsigned pk2(float lo, float hi) { f32x2_t v = {lo, hi}; bf16x2_t b = __builtin_convertvector(v, bf16x2_t); return __builtin_bit_cast(unsigned, b); }
__device__ __forceinline__ float bf_lo(unsigned w) { return __uint_as_float(w << 16); }
__device__ __forceinline__ float bf_hi(unsigned w) { return __uint_as_float(w & 0xffff0000u); }
__device__ __forceinline__ float wave_sum(float v) {
#pragma unroll
    for (int o = 1; o < 64; o <<= 1) v += __shfl_xor(v, o);
    return v;
}

#define CAS __attribute__((address_space(4)))
struct Args { const float* in[27]; float* out; unsigned char* ws; int ph_lo, ph_hi; };
struct Frame {
    LAS unsigned char* lds; volatile LAS unsigned* MISC;
    int tid, lane, wave, vcu, G;
    const CAS Args* ap;
};
#define FRESH_TID() do { int t_ = F.tid; asm volatile("" : "+v"(t_)); F.tid = t_; F.lane = t_ & 63; F.wave = __builtin_amdgcn_readfirstlane(t_ >> 6); } while (0)
#define ARGS() const CAS Args* A_; asm volatile("" : "=s"(A_) : "0"(F.ap)); float* const out = (float*)(GAS float*)A_->out; unsigned char* const ws = (unsigned char*)(GAS unsigned char*)A_->ws; (void)out; (void)ws
#define INP(k) ((const float*)(const GAS float*)A_->in[k])
#define XIN_ROW(m) ((m) < MP ? INP(0) + (size_t)(m) * D : INP(1) + (size_t)((m) - MP) * D)

__device__ __forceinline__ void transpose_item(const float* W, int K, int ldw, const float* gain, bf16* WT, int mode, LAS float* scr, int item, int lane) {
    const int nblk = ldw / 32, kb = item / nblk, nb = item % nblk, k0 = 64 * kb, n0 = 32 * nb;
    const int drow = mode == 0 ? n0 : (256 * (n0 >> 7) + (n0 & 127) + (mode == 2 ? 128 : 0));
#pragma unroll 8
    for (int i = 0; i < 32; ++i) { const int kk = 2 * i + (lane >> 5); float w = W[(size_t)(k0 + kk) * ldw + n0 + (lane & 31)]; if (gain) w *= gain[k0 + kk]; scr[kk * 33 + (lane & 31)] = w; }
    LDS_WAIT(); asm volatile("" ::: "memory");
    const int c = lane & 7;
#pragma unroll
    for (int j = 0; j < 4; ++j) { const int n = (lane >> 3) + 8 * j; const LAS float* s = scr + (8 * c) * 33 + n;
        v4u o; o.x = pk2(s[0 * 33], s[1 * 33]); o.y = pk2(s[2 * 33], s[3 * 33]); o.z = pk2(s[4 * 33], s[5 * 33]); o.w = pk2(s[6 * 33], s[7 * 33]);
        *(v4u*)(WT + (size_t)(drow + n) * K + k0 + 8 * c) = o; }
    LDS_WAIT(); asm volatile("" ::: "memory");
}
__device__ __forceinline__ void rms_row_to_bf16(const Frame& F, const float* xrow, bf16* orow) {
    const f32x4* xr = (const f32x4*)xrow + F.lane;
    f32x4 v[4]; float s = 0.f;
#pragma unroll
    for (int j = 0; j < 4; ++j) { v[j] = xr[64 * j]; s += (v[j].x * v[j].x + v[j].y * v[j].y) + (v[j].z * v[j].z + v[j].w * v[j].w); }
    const float rstd = 1.f / sqrtf(wave_sum(s) * (1.f / D) + RMS_EPS);
    u32x2* o8 = (u32x2*)orow + F.lane;
#pragma unroll
    for (int j = 0; j < 4; ++j) o8[64 * j] = (u32x2){pk2(v[j].x * rstd, v[j].y * rstd), pk2(v[j].z * rstd, v[j].w * rstd)};
}
__device__ __forceinline__ void p0_prologue(Frame& F) {
    FRESH_TID();
    LAS float* scr = (LAS float*)(F.lds + F.wave * 16384);
    const int gw = F.vcu * NWAVES + F.wave, NGW = F.G * NWAVES;
    ARGS();
    constexpr int I_IN = 16 * 64, I_SQ = 16 * 32, I_KV = 16 * 8, I_GU = 16 * 88, I_DN = 44 * 32;
    constexpr int NITEMS = 2 * I_IN + 2 * I_SQ + I_SQ + I_KV + I_SQ + 2 * I_SQ + 4 * (2 * I_GU + I_DN);
#define TR(NI, Wsrc, Kd, Nd, gainp, WTdst, mode) if (r < (NI)) { transpose_item(Wsrc, Kd, Nd, gainp, (bf16*)(WTdst), mode, scr, r, F.lane); continue; } r -= (NI);
    for (int it = gw; it < NITEMS; it += NGW) {
        int r = it;
        TR(I_IN, INP(5), D, 2048, INP(4), ws + WS_WIN, 0)
        TR(I_IN, INP(5) + (size_t)D * 2048, D, 2048, INP(4) + D, ws + WS_WIN + 4 * MiB, 0)
        TR(I_SQ, INP(10), D, D, nullptr, ws + WS_WOUT, 0)
        TR(I_SQ, INP(10) + (size_t)D * D, D, D, nullptr, ws + WS_WOUT + 2 * MiB, 0)
        TR(I_SQ, INP(16), D, D, INP(15), ws + WS_WQKV, 0)
        TR(I_KV, INP(13), D, 256, INP(12), ws + WS_WQKV + 2 * MiB, 0)
        TR(I_SQ, INP(16) + (size_t)D * D, D, D, INP(15) + D, ws + WS_WQ3, 0)
        TR(I_SQ, INP(19), D, D, nullptr, ws + WS_WO, 0)
        TR(I_SQ, INP(19) + (size_t)D * D, D, D, nullptr, ws + WS_WO + 2 * MiB, 0)
#pragma unroll 1
        for (int l = 0; l < 4; ++l) {
            if (r < I_GU) { transpose_item(INP(23) + (size_t)l * D * FF, D, FF, INP(22) + l * D, (bf16*)(ws + WS_WGU + l * 11 * MiB), 1, scr, r, F.lane); r = -1; break; } r -= I_GU;
            if (r < I_GU) { transpose_item(INP(24) + (size_t)l * D * FF, D, FF, INP(22) + l * D, (bf16*)(ws + WS_WGU + l * 11 * MiB), 2, scr, r, F.lane); r = -1; break; } r -= I_GU;
            if (r < I_DN) { transpose_item(INP(25) + (size_t)l * FF * D, FF, D, nullptr, (bf16*)(ws + WS_WD + l * (5 * MiB + 512 * KiB)), 0, scr, r, F.lane); r = -1; break; } r -= I_DN;
        }
    }
#undef TR
    {
        bf16* wsp = (bf16*)(ws + WS_WS); bf16* wss = wsp + 2 * 8 * 128 * 128; const float* w_s = INP(8);
        const int gt = F.vcu * (NWAVES * 64) + F.tid, NT = F.G * NWAVES * 64;
        for (int e = gt; e < 2 * 8 * 128 * 128; e += NT) { const int s = e & 127, t = (e >> 7) & 127, lg = e >> 14;
            wsp[e] = (bf16)(pk2(s <= t ? w_s[e] : 0.f, 0.f) & 0xffffu);
            const bool on = (t >> 3) == (s >> 3) && (s & 7) <= (t & 7);
            wss[e] = (bf16)(pk2(on ? w_s[(size_t)lg * 16384 + (t & 7) * 128 + (s & 7)] : 0.f, 0.f) & 0xffffu); }
    }
    if (F.vcu == 0) { float* bc = (float*)(ws + WS_BQKV); for (int e = F.tid; e < 1280; e += NWAVES * 64) bc[e] = e < 1024 ? INP(17)[e] : INP(14)[e - 1024]; }
    for (int m = gw; m < M; m += NGW) rms_row_to_bf16(F, XIN_ROW(m), (bf16*)(ws + WS_HN) + (size_t)m * D);
}

__device__ __forceinline__ void norm_phase(Frame& F, bool first, int gsel, int gidx) {
    FRESH_TID();
    const int gw = F.vcu * NWAVES + F.wave, NGW = F.G * NWAVES;
    ARGS();
    const float* gpost = INP(gsel) + gidx * D;
    f32x4 g[4];
#pragma unroll
    for (int j = 0; j < 4; ++j) g[j] = ((const f32x4*)gpost)[F.lane + 64 * j];
    for (int m = gw; m < M; m += NGW) {
        const float* xrow = first ? XIN_ROW(m) : out + (size_t)m * D;
        float* xo = out + (size_t)m * D;
        u32x2* hrow = (u32x2*)((bf16*)(ws + WS_HN) + (size_t)m * D) + F.lane;
        f32x4 x[4], o[4]; float s = 0.f;
#pragma unroll
        for (int j = 0; j < 4; ++j) { x[j] = ((const f32x4*)xrow)[F.lane + 64 * j]; const u32x2 w = hrow[64 * j];
            o[j] = (f32x4){bf_lo(w.x), bf_hi(w.x), bf_lo(w.y), bf_hi(w.y)}; s += (o[j].x * o[j].x + o[j].y * o[j].y) + (o[j].z * o[j].z + o[j].w * o[j].w); }
        const float r0 = 1.f / sqrtf(wave_sum(s) * (1.f / D) + RMS_EPS); float s1 = 0.f;
#pragma unroll
        for (int j = 0; j < 4; ++j) { x[j] = x[j] + o[j] * r0 * g[j]; s1 += (x[j].x * x[j].x + x[j].y * x[j].y) + (x[j].z * x[j].z + x[j].w * x[j].w); }
        const float r1 = 1.f / sqrtf(wave_sum(s1) * (1.f / D) + RMS_EPS);
#pragma unroll
        for (int j = 0; j < 4; ++j) { ((f32x4*)xo)[F.lane + 64 * j] = x[j]; hrow[64 * j] = (u32x2){pk2(x[j].x * r1, x[j].y * r1), pk2(x[j].z * r1, x[j].w * r1)}; }
    }
}

constexpr int MIX_VTP = 136;
__device__ __forceinline__ void mix_phase(Frame& F, int l) {
    FRESH_TID();
    LAS unsigned short* VT = (LAS unsigned short*)F.lds;
    LAS float* ST = (LAS float*)(F.lds + 128 * MIX_VTP * 2);
    ARGS();
    bf16* U = (bf16*)(ws + WS_U); const bf16* V = (const bf16*)(ws + WS_V); const float* vstat = (const float*)(ws + WS_VSTAT);
    const float* lng = INP(6) + l * D; const float* lnb = INP(7) + l * D; const float* bs = INP(9) + l * 8 * 128;
    const int lane = F.lane, w = F.wave, fr = lane & 15, fq = lane >> 4;
    for (int u = F.vcu; u < 1088; u += F.G) {
        const bool smp = u >= 1024; const int c = smp ? (u - 1024) >> 3 : u >> 3, g = u & 7;
        const int r0 = smp ? MP + 128 * c : 128 * c;
        const bf16* Wg = (const bf16*)(ws + WS_WS) + (size_t)((smp ? 16 : 0) + l * 8 + g) * 16384;
        float* sv = nullptr;
        if (smp) sv = out + O_SVS + (size_t)l * (128 * 8 * 1024) + (size_t)(r0 - MP) * 1024;
        else if ((c & 63) == 63) sv = out + O_SVP + (size_t)((l * 2 + (c >> 6)) * 128) * 1024;
        if (F.tid < 128) { const f32x4* p = (const f32x4*)(vstat + (size_t)(r0 + F.tid) * 32); float s = 0.f, q = 0.f;
#pragma unroll
            for (int i = 0; i < 8; ++i) { const f32x4 a = p[i]; s += a.x + a.z; q += a.y + a.w; }
            const float mean = s * (1.f / D), var = q * (1.f / D) - mean * mean;
            ST[2 * F.tid] = mean; ST[2 * F.tid + 1] = 1.f / sqrtf(fmaxf(var, 0.f) + LN_EPS); }
        __syncthreads();
#pragma unroll
        for (int i = 0; i < 4; ++i) { const int idx = F.tid + 512 * i, s = idx >> 4, cb = idx & 15, ch = 128 * g + 8 * cb;
            const v4u raw = *(const v4u*)(V + (size_t)(r0 + s) * D + ch);
            const float mean = ST[2 * s], rstd = ST[2 * s + 1];
            const f32x4 g0 = *(const f32x4*)(lng + ch), g1 = *(const f32x4*)(lng + ch + 4), b0 = *(const f32x4*)(lnb + ch), b1 = *(const f32x4*)(lnb + ch + 4);
            f32x4 v0 = {bf_lo(raw.x), bf_hi(raw.x), bf_lo(raw.y), bf_hi(raw.y)}, v1 = {bf_lo(raw.z), bf_hi(raw.z), bf_lo(raw.w), bf_hi(raw.w)};
            v0 = (v0 - mean) * rstd * g0 + b0; v1 = (v1 - mean) * rstd * g1 + b1;
            if (sv) { float* d = sv + (size_t)s * 1024 + ch; *(f32x4*)d = v0; *(f32x4*)(d + 4) = v1; }
            const unsigned p0 = pk2(v0.x, v0.y), p1 = pk2(v0.z, v0.w), p2 = pk2(v1.x, v1.y), p3 = pk2(v1.z, v1.w);
            LAS unsigned short* vt = VT + (8 * cb) * MIX_VTP + s;
            vt[0 * MIX_VTP] = (unsigned short)p0; vt[1 * MIX_VTP] = (unsigned short)(p0 >> 16); vt[2 * MIX_VTP] = (unsigned short)p1; vt[3 * MIX_VTP] = (unsigned short)(p1 >> 16);
            vt[4 * MIX_VTP] = (unsigned short)p2; vt[5 * MIX_VTP] = (unsigned short)(p2 >> 16); vt[6 * MIX_VTP] = (unsigned short)p3; vt[7 * MIX_VTP] = (unsigned short)(p3 >> 16); }
        __syncthreads();
        f32x4 acc[8];
#pragma unroll
        for (int n = 0; n < 8; ++n) acc[n] = (f32x4){0.f, 0.f, 0.f, 0.f};
        const int t = 16 * w + fr;
        for (int kk = 0; kk <= (w >> 1); ++kk) {
            const bf16x8 wf = *(const bf16x8*)(Wg + t * 128 + 32 * kk + 8 * fq);
#pragma unroll
            for (int n = 0; n < 8; ++n) { const bf16x8 vf = *(const LAS bf16x8*)(VT + (16 * n + fr) * MIX_VTP + 32 * kk + 8 * fq);
                acc[n] = __builtin_amdgcn_mfma_f32_16x16x32_bf16(vf, wf, acc[n], 0, 0, 0); }
        }
        const float bias = bs[g * 128 + (smp ? (t & 7) : t)];
        bf16* urow = U + (size_t)(r0 + t) * D + 128 * g + 4 * fq;
#pragma unroll
        for (int n = 0; n < 8; ++n) { u32x2* p = (u32x2*)(urow + 16 * n); const u32x2 uw = *p;
            const float y0 = bf_lo(uw.x) * (acc[n][0] + bias), y1 = bf_hi(uw.x) * (acc[n][1] + bias), y2 = bf_lo(uw.y) * (acc[n][2] + bias), y3 = bf_hi(uw.y) * (acc[n][3] + bias);
            *p = (u32x2){pk2(y0, y1), pk2(y2, y3)}; }
        __syncthreads();
    }
}

namespace att {
constexpr int KP = 72;
__device__ __forceinline__ int crow(int r, int hi) { return (r & 3) + 8 * (r >> 2) + 4 * hi; }
template <bool SAMPLE>
__device__ __forceinline__ void cols32(const LAS unsigned short* Ks, const LAS unsigned short* VTs, int vtp, const bf16* qptr, float sink2, int kb0, bf16* obase, int lane) {
    const int ql = lane & 31, hi = lane >> 5;
    bf16x8 qf[4];
#pragma unroll
    for (int s = 0; s < 4; ++s) qf[s] = *(const bf16x8*)(qptr + 16 * s + 8 * hi);
    f32x16 S[5];
#pragma unroll
    for (int kb = 0; kb < 5; ++kb) {
        f32x16 a;
#pragma unroll
        for (int r = 0; r < 16; ++r) a[r] = 0.f;
        if (kb >= kb0) {
#pragma unroll
            for (int s = 0; s < 4; ++s) { const bf16x8 kf = *(const LAS bf16x8*)(Ks + (32 * kb + ql) * KP + 16 * s + 8 * hi); a = __builtin_amdgcn_mfma_f32_32x32x16_bf16(kf, qf[s], a, 0, 0, 0); }
        }
        S[kb] = a;
    }
    float mx = sink2;
#pragma unroll
    for (int kb = 0; kb < 5; ++kb)
#pragma unroll
        for (int r = 0; r < 16; ++r) { const int kr = crow(r, hi); bool valid;
            if (SAMPLE) { const int j = 32 * kb + kr, t = ql & 7; valid = (j < 128) ? (j > t) : (j - 128 <= t); }
            else valid = kb >= kb0 && (kb == 0 ? kr > ql : (kb == 4 ? kr <= ql : true));
            const float v = valid ? S[kb][r] : -INFINITY; S[kb][r] = v; mx = fmaxf(mx, v); }
    mx = fmaxf(mx, __shfl_xor(mx, 32));
    float sum = 0.f;
#pragma unroll
    for (int kb = 0; kb < 5; ++kb)
#pragma unroll
        for (int r = 0; r < 16; ++r) { const float p = __builtin_amdgcn_exp2f(S[kb][r] - mx); S[kb][r] = p; sum += p; }
    sum += __shfl_xor(sum, 32); sum += __builtin_amdgcn_exp2f(sink2 - mx);
    const float inv = 1.0f / sum;
    f32x16 o0, o1;
#pragma unroll
    for (int r = 0; r < 16; ++r) { o0[r] = 0.f; o1[r] = 0.f; }
#pragma unroll
    for (int kb = 0; kb < 5; ++kb) {
        if (kb >= kb0) {
#pragma unroll
            for (int s2 = 0; s2 < 2; ++s2) {
                v4u pw; pw.x = pk2(S[kb][8 * s2 + 0] * inv, S[kb][8 * s2 + 1] * inv); pw.y = pk2(S[kb][8 * s2 + 2] * inv, S[kb][8 * s2 + 3] * inv);
                pw.z = pk2(S[kb][8 * s2 + 4] * inv, S[kb][8 * s2 + 5] * inv); pw.w = pk2(S[kb][8 * s2 + 6] * inv, S[kb][8 * s2 + 7] * inv);
                const bf16x8 pf = __builtin_bit_cast(bf16x8, pw);
                const LAS unsigned short* vp = VTs + ql * vtp + 32 * kb + 16 * s2 + 4 * hi;
                const s16x4 a0 = *(const LAS s16x4*)vp, a1 = *(const LAS s16x4*)(vp + 8), b0 = *(const LAS s16x4*)(vp + 32 * vtp), b1 = *(const LAS s16x4*)(vp + 32 * vtp + 8);
                const bf16x8 vf0 = {a0[0], a0[1], a0[2], a0[3], a1[0], a1[1], a1[2], a1[3]}, vf1 = {b0[0], b0[1], b0[2], b0[3], b1[0], b1[1], b1[2], b1[3]};
                o0 = __builtin_amdgcn_mfma_f32_32x32x16_bf16(pf, vf0, o0, 0, 0, 0); o1 = __builtin_amdgcn_mfma_f32_32x32x16_bf16(pf, vf1, o1, 0, 0, 0);
            }
        }
    }
#pragma unroll
    for (int r = 0; r < 16; ++r) { const int q = crow(r, hi); bf16* op = obase + (SAMPLE ? (size_t)(q & 7) * 1024 + (q >> 3) * 64 : (size_t)q * 1024) + ql;
        op[0] = (bf16)(pk2(o0[r], 0.f) & 0xffffu); op[32] = (bf16)(pk2(o1[r], 0.f) & 0xffffu); }
}
}

__device__ __forceinline__ void attn_phase(Frame& F, int li) {
    FRESH_TID();
    ARGS();
    const bf16* Q = (const bf16*)(ws + WS_QO); bf16* O = (bf16*)(ws + WS_QO); const bf16* KV = (const bf16*)(ws + WS_KV);
    const float* sinks = INP(18) + li * 16;
    const int tid = F.tid, lane = F.lane, w = F.wave;
    if (li == 0) {
        for (int e = F.vcu * (NWAVES * 64) + tid; e < 1280 * 32; e += F.G * NWAVES * 64) { const int rr = e >> 5, c8 = (e & 31) * 8;
            const int row = rr < 256 ? (rr >> 7) * SEQ + 8064 + (rr & 127) : MP + (rr - 256);
            const v4u wv = *(const v4u*)(KV + (size_t)row * D + c8);
            const f32x4 v0 = {bf_lo(wv.x), bf_hi(wv.x), bf_lo(wv.y), bf_hi(wv.y)}, v1 = {bf_lo(wv.z), bf_hi(wv.z), bf_lo(wv.w), bf_hi(wv.w)};
            float* d = out + (rr < 256 ? (c8 < 128 ? O_KP : O_VP) + (size_t)rr * 128 : (c8 < 128 ? O_KS : O_VS) + (size_t)(rr - 256) * 128) + (c8 & 127);
            *(f32x4*)d = v0; *(f32x4*)(d + 4) = v1; }
    }
    for (int u = F.vcu; u < 256 + 128; u += F.G) {
        if (u < 256) {
            constexpr int VTP = 264;
            LAS unsigned short* Ks = (LAS unsigned short*)F.lds; LAS unsigned short* VT = Ks + 256 * att::KP;
            const int jb = u & 63, kvh = (u >> 6) & 1, b = u >> 7, q0 = 128 * jb; const size_t R0 = (size_t)b * SEQ;
#pragma unroll
            for (int i = 0; i < 4; ++i) { const int idx = tid + 512 * i, row = idx >> 3, ch = idx & 7;
                if (jb > 0 || row >= 128) { const bf16* src = KV + (R0 + q0 - 128 + row) * D + kvh * 64 + 8 * ch;
                    const v4u kk = *(const v4u*)src, vv = *(const v4u*)(src + 128);
                    *(LAS v4u*)(Ks + row * att::KP + 8 * ch) = kk;
                    LAS unsigned short* vt = VT + (8 * ch) * VTP + row;
                    vt[0 * VTP] = (unsigned short)vv.x; vt[1 * VTP] = (unsigned short)(vv.x >> 16); vt[2 * VTP] = (unsigned short)vv.y; vt[3 * VTP] = (unsigned short)(vv.y >> 16);
                    vt[4 * VTP] = (unsigned short)vv.z; vt[5 * VTP] = (unsigned short)(vv.z >> 16); vt[6 * VTP] = (unsigned short)vv.w; vt[7 * VTP] = (unsigned short)(vv.w >> 16); } }
            __syncthreads();
            const int h = kvh * 8 + w; const float sink2 = sinks[h] * LOG2E;
#pragma unroll 1
            for (int i = 0; i < 4; ++i) {
                const size_t qrow = R0 + q0 + 32 * i;
                att::cols32<false>(Ks + (32 * i) * att::KP, VT + 32 * i, VTP, Q + (qrow + (lane & 31)) * D + h * 64, sink2, jb == 0 ? 4 - i : 0, O + qrow * D + h * 64, lane);
            }
            __syncthreads();
        } else {
            constexpr int VTP = 168;
            const int db = u - 256;
            LAS unsigned short* Ks = (LAS unsigned short*)F.lds; LAS unsigned short* VT = Ks + 2 * 160 * att::KP;
            const float* ck = INP(2) + (size_t)db * 128 * 128; const float* cv = INP(3) + (size_t)db * 128 * 128;
#pragma unroll
            for (int i = 0; i < 8; ++i) { const int idx = tid + 512 * i, d4 = idx & 15, kvh = (idx >> 4) & 1, j = idx >> 5;
                const f32x4 kk = ((const f32x4*)ck)[idx], vv = ((const f32x4*)cv)[idx];
                *(LAS u32x2*)(Ks + (kvh * 160 + j) * att::KP + 4 * d4) = (u32x2){pk2(kk.x, kk.y), pk2(kk.z, kk.w)};
                LAS unsigned short* vt = VT + (kvh * 64 + 4 * d4) * VTP + j; const unsigned p0 = pk2(vv.x, vv.y), p1 = pk2(vv.z, vv.w);
                vt[0] = (unsigned short)p0; vt[VTP] = (unsigned short)(p0 >> 16); vt[2 * VTP] = (unsigned short)p1; vt[3 * VTP] = (unsigned short)(p1 >> 16); }
            { const int t = tid >> 6, c4 = (tid & 63) * 4; const u32x2 wv = *(const u32x2*)(KV + (size_t)(MP + db * 8 + t) * D + c4);
                if (c4 < 128) { *(LAS u32x2*)(Ks + ((c4 >> 6) * 160 + 128 + t) * att::KP + (c4 & 63)) = wv; }
                else { const int cc = c4 - 128; LAS unsigned short* vt = VT + ((cc >> 6) * 64 + (cc & 63)) * VTP + 128 + t;
                    vt[0] = (unsigned short)wv.x; vt[VTP] = (unsigned short)(wv.x >> 16); vt[2 * VTP] = (unsigned short)wv.y; vt[3 * VTP] = (unsigned short)(wv.y >> 16); } }
            for (int idx = tid; idx < 1536; idx += 512) { const int kvh = idx / 768, rem = idx % 768, d = rem / 12, cp = rem % 12;
                *(LAS unsigned*)(VT + (kvh * 64 + d) * VTP + 136 + 2 * cp) = 0u; }
            __syncthreads();
            if (w < 4) { const int kvh = w >> 1, half = w & 1, ql = lane & 31; const int h = kvh * 8 + half * 4 + (ql >> 3);
                const size_t row0 = (size_t)MP + db * 8;
                att::cols32<true>(Ks + kvh * 160 * att::KP, VT + kvh * 64 * VTP, VTP, Q + (row0 + (ql & 7)) * D + h * 64, sinks[h] * LOG2E, 0, O + row0 * D + (kvh * 8 + half * 4) * 64, lane); }
            __syncthreads();
        }
    }
}

#ifndef MK_PER_PHASE
#define MK_PER_PHASE 0
#endif
constexpr int N_PHASES = 1 + 4 * 7;
__global__ void __launch_bounds__(NWAVES * 64, 2) yoco_fwd(Args args) {
    extern __shared__ __attribute__((aligned(16))) unsigned char lds[];
    Frame F;
    F.lds = (LAS unsigned char*)lds; F.MISC = (volatile LAS unsigned*)(F.lds + MISC_OFF);
    F.tid = threadIdx.x; F.lane = F.tid & 63; F.wave = __builtin_amdgcn_readfirstlane(F.tid >> 6);
    F.G = gridDim.x; { const int bx = blockIdx.x; F.vcu = (F.G % 8 == 0) ? (bx % 8) * (F.G / 8) + bx / 8 : bx; }
    F.ap = (const CAS Args*)__builtin_amdgcn_kernarg_segment_ptr();
    for (int u = F.tid; u < (LDS_BYTES - LDSCTL_OFF) / 4; u += NWAVES * 64) ((LAS unsigned*)(F.lds + LDSCTL_OFF))[u] = 0u;
    __syncthreads();
    XcdBarrier bar; bar.bar = (unsigned*)(args.ws + WS_CTL) + CW_BAR; bar.x = 0; bar.st = nullptr;
    if (!MK_PER_PHASE) bar = xcd_barrier_post((unsigned*)(args.ws + WS_CTL) + CW_BAR, F.MISC + 8);
    const int lo = args.ph_lo, hi = args.ph_hi;
    int ph = 0;
#define IN_PH() (lo <= ph && ph < hi)
#define END_PH() do { if (IN_PH() && ph + 1 < hi) { if (!MK_PER_PHASE) { XcdBarrier b2_ = bar; asm volatile("" : "+s"(b2_.bar), "+s"(b2_.x)); xcd_barrier(b2_); } } ++ph; } while (0)
#ifndef NO_P0
    if (IN_PH()) p0_prologue(F);
#endif
    END_PH();
#pragma unroll 1
    for (int l = 0; l < 4; ++l) {
        if (l < 2) {
            if (IN_PH()) { ARGS(); pg8::Gemm g{(const bf16*)(ws + WS_HN), (const bf16*)(ws + WS_WIN + l * 4 * MiB), M, 2048, D}; pg8::StaticOrder S; S.init(M, 2048, F.G, (int)blockIdx.x);
                pg8::EpiGeluUV E{(bf16*)(ws + WS_U), (bf16*)(ws + WS_V), (float*)(ws + WS_VSTAT)};
#ifndef NO_G1
                pg8::gemm_phase<pg8::EpiGeluUV, pg8::StaticOrder, true, true>(F.lds, g, S, E);
#endif
            }
            END_PH();
#ifndef NO_MIX
            if (IN_PH()) mix_phase(F, l);
#endif
            END_PH();
        } else {
            const int li = l - 2;
            if (IN_PH()) { ARGS(); const int N = li == 0 ? 1280 : 1024;
                pg8::Gemm g{(const bf16*)(ws + WS_HN), (const bf16*)(ws + (li == 0 ? WS_WQKV : WS_WQ3)), M, N, D}; pg8::StaticOrder S; S.init(M, N, F.G, (int)blockIdx.x);
                pg8::EpiBf16<0> E{(bf16*)(ws + WS_QO), D, li == 0 ? (const float*)(ws + WS_BQKV) : INP(17) + D, 1024, (size_t)(WS_KV - WS_QO) / 2, QSCALE};
#ifndef NO_GQ
                pg8::gemm_phase<pg8::EpiBf16<0>, pg8::StaticOrder, true, true>(F.lds, g, S, E);
#endif
            }
            END_PH();
#ifndef NO_ATTN
            if (IN_PH()) attn_phase(F, li);
#endif
            END_PH();
        }
#pragma unroll 1
        for (int half = 0; half < 2; ++half) {
            if (half == 1) {
                if (IN_PH()) { ARGS(); pg8::Gemm g{(const bf16*)(ws + WS_HN), (const bf16*)(ws + WS_WGU + l * 11 * MiB), M, NGU, D}; pg8::StaticOrder S; S.init(M, NGU, F.G, (int)blockIdx.x);
                    pg8::EpiSwiglu E{(bf16*)(ws + WS_HID), FF};
#ifndef NO_G3
                    pg8::gemm_phase<pg8::EpiSwiglu, pg8::StaticOrder, true, true>(F.lds, g, S, E);
#endif
                }
                END_PH();
            }
            if (IN_PH()) { ARGS();
                const bf16* A; const bf16* Bt; int K; const float* bias = nullptr;
                if (half == 1) { A = (const bf16*)(ws + WS_HID); Bt = (const bf16*)(ws + WS_WD + l * (5 * MiB + 512 * KiB)); K = FF; }
                else if (l < 2) { A = (const bf16*)(ws + WS_U); Bt = (const bf16*)(ws + WS_WOUT + l * 2 * MiB); K = D; }
                else { A = (const bf16*)(ws + WS_QO); Bt = (const bf16*)(ws + WS_WO + (l - 2) * 2 * MiB); K = D; bias = INP(20) + (l - 2) * D; }
                pg8::Gemm g{A, Bt, M, D, K}; pg8::StaticOrder S; S.init(M, D, F.G, (int)blockIdx.x);
                pg8::EpiBf16<0> E{(bf16*)(ws + WS_HN), D, bias, 0, 0, 1.f};
#ifndef NO_GO
                pg8::gemm_phase<pg8::EpiBf16<0>, pg8::StaticOrder, true, true>(F.lds, g, S, E);
#endif
            }
            END_PH();
#ifndef NO_NORM
            if (IN_PH()) norm_phase(F, l == 0 && half == 0, half == 1 ? 26 : (l < 2 ? 11 : 21), half == 1 ? l : (l < 2 ? l : l - 2));
#endif
            END_PH();
        }
    }
#undef IN_PH
#undef END_PH
}

extern "C" void kernel_launch(void* const* d_in, const int* in_sizes, int n_in, void* d_out, int out_size, void* d_ws, size_t ws_size, hipStream_t stream) {
    static int grid = 0;
    if (grid == 0) {
        if (n_in != 27 || out_size != 20774912 || ws_size < WS_END) { fprintf(stderr, "kernel_launch: unexpected problem: n_in %d out %d ws %zu (need %zu)\n", n_in, out_size, ws_size, (size_t)WS_END); grid = -1; return; }
        int dev = 0, cus = 0, per_cu = 0;
        if (hipGetDevice(&dev) != hipSuccess || hipDeviceGetAttribute(&cus, hipDeviceAttributeMultiprocessorCount, dev) != hipSuccess) { grid = -1; return; }
        if (hipFuncSetAttribute((const void*)yoco_fwd, hipFuncAttributeMaxDynamicSharedMemorySize, LDS_BYTES) != hipSuccess) { fprintf(stderr, "kernel_launch: hipFuncSetAttribute failed\n"); grid = -1; return; }
        if (hipOccupancyMaxActiveBlocksPerMultiprocessor(&per_cu, (const void*)yoco_fwd, NWAVES * 64, LDS_BYTES) != hipSuccess || per_cu < 1) fprintf(stderr, "kernel_launch: occupancy query says %d\n", per_cu);
        (void)hipGetLastError();
        grid = cus;
    }
    if (grid < 0) return;
    (void)hipMemsetAsync((char*)d_ws + WS_CTL, 0, CTL_ZERO_BYTES, stream);
    Args a{};
    for (int i = 0; i < 27; ++i) a.in[i] = (const float*)d_in[i];
    a.out = (float*)d_out; a.ws = (unsigned char*)d_ws;
#if MK_PER_PHASE
    for (int p = 0; p < N_PHASES; ++p) { a.ph_lo = p; a.ph_hi = p + 1; hipLaunchKernelGGL(yoco_fwd, dim3(grid), dim3(NWAVES * 64), LDS_BYTES, stream, a); }
#else
    a.ph_lo = 0; a.ph_hi = N_PHASES;
    hipLaunchKernelGGL(yoco_fwd, dim3(grid), dim3(NWAVES * 64), LDS_BYTES, stream, a);
#endif
}
```
